# Optimizing an MI355X kernel written in HIP

```python
import jax, jax.numpy as jnp
from jax import lax
import numpy as np

D_MODEL = 1024
BATCH = 2
SEQ = 16384
DEPTH = 1
DEC_BATCH = 32
DEC_SEQ = 32
PAST_LEN = 2048

CHUNK = 64
D_MIX = D_MODEL
W_A = D_MIX // 2
W_B = D_MIX - W_A
N_HEADS_A = 8
CONV_W = 3
HIST_C = CONV_W - 1
POOL_WINDOWS = (2, 4, 8, 16)
N_GROUPS_B = len(POOL_WINDOWS)
GC = W_B // N_GROUPS_B
HIST_P = max(POOL_WINDOWS) - 1
PLE_DIM = 256
PROJ_W = 4 * W_A + 2 * W_B
EPS = 1e-6

kernel_name = "hybrid_shortconv_pool_stream_step"


def rmsnorm(x, g):
    x32 = x.astype(jnp.float32)
    y = x32 * lax.rsqrt(jnp.mean(x32 * x32, axis=-1, keepdims=True) + EPS)
    return (y * g.astype(jnp.float32)).astype(x.dtype)


def short_conv_mixer(hA, bA, cA, zA, hist, conv_w, conv_b):
    T = hA.shape[1]
    u = cA * hA
    uu = jnp.concatenate([hist.astype(u.dtype), u], axis=1)
    c = (uu[:, 0:T] * conv_w[0] + uu[:, 1:1 + T] * conv_w[1]
         + uu[:, 2:2 + T] * conv_w[2] + conv_b)
    y = bA * c * jax.nn.silu(zA)
    return y, uu[:, -HIST_C:]


def pooling_mixer(vB, zB, hist, pos, pool_w, pool_scale):
    Bsz, T, _ = vB.shape
    vv = jnp.concatenate([hist.astype(vB.dtype), vB], axis=1).astype(jnp.float32)
    cs = jnp.concatenate([jnp.zeros((Bsz, 1, W_B), jnp.float32),
                          jnp.cumsum(vv, axis=1)], axis=1)
    v32 = vB.astype(jnp.float32)
    outs = []
    for g, w in enumerate(POOL_WINDOWS):
        sl = slice(g * GC, (g + 1) * GC)
        s = cs[:, HIST_P + 1:HIST_P + 1 + T, sl] - cs[:, HIST_P + 1 - w:HIST_P + 1 - w + T, sl]
        cnt = jnp.minimum(pos + 1, w).astype(jnp.float32)[None, :, None]
        outs.append(s / cnt - v32[:, :, sl])
    pooled = jnp.concatenate(outs, axis=-1).astype(vB.dtype)
    pg = pooled.reshape(Bsz, T, N_GROUPS_B, GC)
    mixed = jnp.einsum('btgc,gcd->btgd', pg, pool_w).reshape(Bsz, T, W_B) * pool_scale
    y = mixed * jax.nn.silu(zB)
    return y, vv[:, -HIST_P:].astype(vB.dtype)


def layer(h, p, conv_hist, pool_hist, pos, g_mix, w_in, conv_w, conv_b, pool_w, pool_scale,
          w_out, g_ple, w_ple_gate, w_ple):
    hn = rmsnorm(h, g_mix)
    proj = hn @ w_in
    hA, bA, cA, zA, vB, zB = jnp.split(
        proj, [W_A, 2 * W_A, 3 * W_A, 4 * W_A, 4 * W_A + W_B], axis=-1)
    yA, new_conv = short_conv_mixer(hA, bA, cA, zA, conv_hist, conv_w, conv_b)
    yB, new_pool = pooling_mixer(vB, zB, pool_hist, pos, pool_w, pool_scale)
    h = h + jnp.concatenate([yA, yB], axis=-1) @ w_out
    gate = jax.nn.sigmoid(rmsnorm(h, g_ple) @ w_ple_gate)
    h = h + (p @ w_ple) * gate
    return h, new_conv, new_pool


def run_trunk(x, p, conv_hist, pool_hist, pos, g_mix, w_in, conv_w, conv_b, pool_w, pool_scale,
              w_out, g_ple, w_ple_gate, w_ple, g_final):
    h = x
    convs, pools = [], []
    for i in range(DEPTH):
        h, nc, npl = layer(h, p[i], conv_hist[i], pool_hist[i], pos, g_mix[i], w_in[i],
                           conv_w[i], conv_b[i], pool_w[i], pool_scale[i], w_out[i],
                           g_ple[i], w_ple_gate[i], w_ple[i])
        convs.append(nc)
        pools.append(npl)
    return rmsnorm(h, g_final), jnp.stack(convs, 0), jnp.stack(pools, 0)


def setup_inputs(seed: int = 0) -> dict:
    key = jax.random.key(seed)
    ks = jax.random.split(key, 20)
    f32 = jnp.float32
    nrm = lambda k, shape, s: jax.random.normal(k, shape, f32) * s
    return {
        "x_prompt": nrm(ks[0], (BATCH, SEQ, D_MODEL), 1.0),
        "x_sample": nrm(ks[1], (DEC_BATCH, DEC_SEQ, D_MODEL), 1.0),
        "cache_conv": nrm(ks[2], (DEPTH, DEC_BATCH, HIST_C, W_A), 1.0),
        "cache_pool": nrm(ks[3], (DEPTH, DEC_BATCH, HIST_P, W_B), 1.0),
        "p_prompt": nrm(ks[4], (DEPTH, BATCH, SEQ, PLE_DIM), 1.0),
        "p_sample": nrm(ks[5], (DEPTH, DEC_BATCH, DEC_SEQ, PLE_DIM), 1.0),
        "g_mix": 1.0 + nrm(ks[6], (DEPTH, D_MODEL), 0.05),
        "w_in": nrm(ks[7], (DEPTH, D_MODEL, PROJ_W), D_MODEL ** -0.5),
        "conv_w": nrm(ks[8], (DEPTH, CONV_W, W_A), CONV_W ** -0.5),
        "conv_b": nrm(ks[9], (DEPTH, W_A), 0.02),
        "pool_w": nrm(ks[10], (DEPTH, N_GROUPS_B, GC, GC), GC ** -0.5),
        "pool_scale": 1.0 + nrm(ks[11], (DEPTH, W_B), 0.1),
        "w_out": nrm(ks[12], (DEPTH, D_MIX, D_MODEL), D_MIX ** -0.5),
        "g_ple": 1.0 + nrm(ks[13], (DEPTH, D_MODEL), 0.05),
        "w_ple_gate": nrm(ks[14], (DEPTH, D_MODEL, D_MODEL), D_MODEL ** -0.5),
        "w_ple": nrm(ks[15], (DEPTH, PLE_DIM, D_MODEL), PLE_DIM ** -0.5),
        "g_final": 1.0 + nrm(ks[16], (D_MODEL,), 0.05),
    }


def reference(x_prompt, x_sample, cache_conv, cache_pool, p_prompt, p_sample, g_mix, w_in,
              conv_w, conv_b, pool_w, pool_scale, w_out, g_ple, w_ple_gate, w_ple, g_final):
    conv0 = jnp.zeros((DEPTH, BATCH, HIST_C, W_A), x_prompt.dtype)
    pool0 = jnp.zeros((DEPTH, BATCH, HIST_P, W_B), x_prompt.dtype)
    pos_prompt = jnp.arange(SEQ, dtype=jnp.int32)
    y_prompt, state_conv_prompt, state_pool_prompt = run_trunk(
        x_prompt, p_prompt, conv0, pool0, pos_prompt, g_mix, w_in, conv_w, conv_b, pool_w,
        pool_scale, w_out, g_ple, w_ple_gate, w_ple, g_final)
    T = x_sample.shape[1]
    pos_sample = PAST_LEN + jnp.arange(T, dtype=jnp.int32)
    y_sample, state_conv_sample, state_pool_sample = run_trunk(
        x_sample, p_sample, cache_conv, cache_pool, pos_sample, g_mix, w_in, conv_w, conv_b,
        pool_w, pool_scale, w_out, g_ple, w_ple_gate, w_ple, g_final)
    return (y_prompt, y_sample, state_conv_prompt, state_pool_prompt, state_conv_sample, state_pool_sample)
```

```cpp
#include <hip/hip_runtime.h>
#include <cstdio>
#include <cstdint>

#define D_MODEL 1024
#define W_A 512
#define W_B 512
#define PROJ_W 3072
#define PLE 256
#define EPSF 1e-6f

__global__ void __launch_bounds__(256) k_rmsnorm(const float* __restrict__ x, const float* __restrict__ g, float* __restrict__ out, int rows) {
    const int r = blockIdx.x; if (r >= rows) return;
    const float4 v = ((const float4*)(x + (size_t)r * D_MODEL))[threadIdx.x];
    float s = v.x * v.x + v.y * v.y + v.z * v.z + v.w * v.w;
    for (int o = 32; o >= 1; o >>= 1) s += __shfl_xor(s, o);
    __shared__ float red[4];
    if ((threadIdx.x & 63) == 0) red[threadIdx.x >> 6] = s;
    __syncthreads();
    const float tot = red[0] + red[1] + red[2] + red[3];
    const float rs = rsqrtf(tot * (1.0f / D_MODEL) + EPSF);
    const float4 gg = ((const float4*)g)[threadIdx.x];
    float4 o; o.x = v.x * rs * gg.x; o.y = v.y * rs * gg.y; o.z = v.z * rs * gg.z; o.w = v.w * rs * gg.w;
    ((float4*)(out + (size_t)r * D_MODEL))[threadIdx.x] = o;
}

__global__ void __launch_bounds__(256) k_sgemm(const float* __restrict__ A, int lda, const float* __restrict__ B, int ldb, float* __restrict__ C, int ldc, int K) {
    __shared__ float As[16][64 + 4];
    __shared__ float Bs[16][64 + 4];
    const int tx = threadIdx.x & 15, ty = threadIdx.x >> 4;
    const int m0 = blockIdx.y * 64, n0 = blockIdx.x * 64;
    float acc[4][4];
#pragma unroll
    for (int i = 0; i < 4; ++i)
#pragma unroll
        for (int j = 0; j < 4; ++j) acc[i][j] = 0.f;
    for (int k0 = 0; k0 < K; k0 += 16) {
        {
            const int r = threadIdx.x >> 2, c = (threadIdx.x & 3) * 4;
            const float4 v = *(const float4*)(A + (size_t)(m0 + r) * lda + k0 + c);
            As[c + 0][r] = v.x; As[c + 1][r] = v.y; As[c + 2][r] = v.z; As[c + 3][r] = v.w;
        }
        {
            const int r = threadIdx.x >> 4, c = (threadIdx.x & 15) * 4;
            const float4 v = *(const float4*)(B + (size_t)(k0 + r) * ldb + n0 + c);
            Bs[r][c + 0] = v.x; Bs[r][c + 1] = v.y; Bs[r][c + 2] = v.z; Bs[r][c + 3] = v.w;
        }
        __syncthreads();
#pragma unroll
        for (int k = 0; k < 16; ++k) {
            float a[4], b[4];
#pragma unroll
            for (int i = 0; i < 4; ++i) a[i] = As[k][ty * 4 + i];
#pragma unroll
            for (int j = 0; j < 4; ++j) b[j] = Bs[k][tx * 4 + j];
#pragma unroll
            for (int i = 0; i < 4; ++i)
#pragma unroll
                for (int j = 0; j < 4; ++j) acc[i][j] = fmaf(a[i], b[j], acc[i][j]);
        }
        __syncthreads();
    }
#pragma unroll
    for (int i = 0; i < 4; ++i) {
        float4 o; o.x = acc[i][0]; o.y = acc[i][1]; o.z = acc[i][2]; o.w = acc[i][3];
        *(float4*)(C + (size_t)(m0 + ty * 4 + i) * ldc + n0 + tx * 4) = o;
    }
}

__device__ __forceinline__ float silu_f(float z) { return z / (1.0f + __expf(-z)); }
__device__ __forceinline__ float sigmoid_f(float z) { return 1.0f / (1.0f + __expf(-z)); }

__global__ void k_mix_conv(const float* __restrict__ proj, const float* __restrict__ hist, const float* __restrict__ conv_w, const float* __restrict__ conv_b,
                           float* __restrict__ y, float* __restrict__ state, int T, int total) {
    const int idx = blockIdx.x * blockDim.x + threadIdx.x; if (idx >= total) return;
    const int ch = idx & 511, row = idx >> 9, seq = row / T, t = row % T;
    const float* pr = proj + (size_t)row * PROJ_W;
    float u[3];
#pragma unroll
    for (int d = 0; d < 3; ++d) {
        const int tt = t - 2 + d;
        if (tt >= 0) { const float* q = proj + (size_t)(row - 2 + d) * PROJ_W; u[d] = q[2 * W_A + ch] * q[ch]; }
        else u[d] = hist ? hist[((size_t)seq * 2 + (tt + 2)) * W_A + ch] : 0.f;
    }
    const float c = u[0] * conv_w[ch] + u[1] * conv_w[W_A + ch] + u[2] * conv_w[2 * W_A + ch] + conv_b[ch];
    const float bA = pr[W_A + ch], zA = pr[3 * W_A + ch];
    y[(size_t)row * D_MODEL + ch] = bA * c * silu_f(zA);
    if (t >= T - 2) state[((size_t)seq * 2 + (t - (T - 2))) * W_A + ch] = u[2];
}

__global__ void k_mix_pool1(const float* __restrict__ proj, const float* __restrict__ hist, float* __restrict__ pooled, float* __restrict__ state, int T, int pos0, int total) {
    const int idx = blockIdx.x * blockDim.x + threadIdx.x; if (idx >= total) return;
    const int ch = idx & 511, row = idx >> 9, seq = row / T, t = row % T;
    const int g = ch >> 7, w = 2 << g;
    float s = 0.f;
    for (int d = 0; d < w; ++d) {
        const int tt = t - d;
        float v;
        if (tt >= 0) v = proj[(size_t)(row - d) * PROJ_W + 4 * W_A + ch];
        else v = hist ? hist[((size_t)seq * 15 + (tt + 15)) * W_B + ch] : 0.f;
        s += v;
    }
    const float v0 = proj[(size_t)row * PROJ_W + 4 * W_A + ch];
    const int pos = pos0 + t;
    const float cnt = (float)((pos + 1) < w ? (pos + 1) : w);
    pooled[(size_t)row * W_B + ch] = s / cnt - v0;
    if (t >= T - 15) state[((size_t)seq * 15 + (t - (T - 15))) * W_B + ch] = v0;
}

__global__ void k_mix_pool2(const float* __restrict__ mixed, const float* __restrict__ proj, const float* __restrict__ scale, float* __restrict__ y, int total) {
    const int idx = blockIdx.x * blockDim.x + threadIdx.x; if (idx >= total) return;
    const int ch = idx & 511, row = idx >> 9;
    const float z = proj[(size_t)row * PROJ_W + 4 * W_A + W_B + ch];
    y[(size_t)row * D_MODEL + W_A + ch] = mixed[(size_t)row * W_B + ch] * scale[ch] * silu_f(z);
}

__global__ void k_add(const float* __restrict__ a, const float* __restrict__ b, float* __restrict__ o, size_t n) {
    const size_t i = (size_t)blockIdx.x * blockDim.x + threadIdx.x; if (i < n) o[i] = a[i] + b[i];
}
__global__ void k_gate(const float* __restrict__ h2, const float* __restrict__ ple, const float* __restrict__ gpre, float* __restrict__ o, size_t n) {
    const size_t i = (size_t)blockIdx.x * blockDim.x + threadIdx.x; if (i < n) o[i] = h2[i] + ple[i] * sigmoid_f(gpre[i]);
}

struct W {
    const float *g_mix, *w_in, *conv_w, *conv_b, *pool_w, *pool_scale, *w_out, *g_ple, *w_gate, *w_ple, *g_final;
};

static void run_trunk(const float* x, const float* p, const float* hconv, const float* hpool, int nseq, int T, int pos0, const W& w,
                      float* yout, float* st_conv, float* st_pool, float* bufA, float* bufP, float* bufY, hipStream_t s) {
    const int rows = nseq * T;
    const size_t nel = (size_t)rows * D_MODEL;
    k_rmsnorm<<<rows, 256, 0, s>>>(x, w.g_mix, bufA, rows);
    k_sgemm<<<dim3(PROJ_W / 64, rows / 64), 256, 0, s>>>(bufA, D_MODEL, w.w_in, PROJ_W, bufP, PROJ_W, D_MODEL);
    const int tot = rows * 512;
    k_mix_conv<<<(tot + 255) / 256, 256, 0, s>>>(bufP, hconv, w.conv_w, w.conv_b, bufY, st_conv, T, tot);
    float* pooled = bufA;
    float* mixed = bufA + (size_t)rows * 512;
    k_mix_pool1<<<(tot + 255) / 256, 256, 0, s>>>(bufP, hpool, pooled, st_pool, T, pos0, tot);
    for (int g = 0; g < 4; ++g)
        k_sgemm<<<dim3(128 / 64, rows / 64), 256, 0, s>>>(pooled + g * 128, W_B, w.pool_w + (size_t)g * 128 * 128, 128, mixed + g * 128, W_B, 128);
    k_mix_pool2<<<(tot + 255) / 256, 256, 0, s>>>(mixed, bufP, w.pool_scale, bufY, tot);
    k_sgemm<<<dim3(D_MODEL / 64, rows / 64), 256, 0, s>>>(bufY, D_MODEL, w.w_out, D_MODEL, bufA, D_MODEL, D_MODEL);
    k_add<<<(unsigned)((nel + 255) / 256), 256, 0, s>>>(x, bufA, yout, nel);
    k_rmsnorm<<<rows, 256, 0, s>>>(yout, w.g_ple, bufA, rows);
    k_sgemm<<<dim3(D_MODEL / 64, rows / 64), 256, 0, s>>>(bufA, D_MODEL, w.w_gate, D_MODEL, bufY, D_MODEL, D_MODEL);
    k_sgemm<<<dim3(D_MODEL / 64, rows / 64), 256, 0, s>>>(p, PLE, w.w_ple, D_MODEL, bufP, D_MODEL, PLE);
    k_gate<<<(unsigned)((nel + 255) / 256), 256, 0, s>>>(yout, bufP, bufY, bufA, nel);
    k_rmsnorm<<<rows, 256, 0, s>>>(bufA, w.g_final, yout, rows);
}

extern "C" void kernel_launch(void* const* d_in, const int* in_sizes, int n_in, void* d_out, int out_size, void* d_ws, size_t ws_size, hipStream_t stream) {
    const float* x_prompt = (const float*)d_in[0];
    const float* x_sample = (const float*)d_in[1];
    const float* cache_conv = (const float*)d_in[2];
    const float* cache_pool = (const float*)d_in[3];
    const float* p_prompt = (const float*)d_in[4];
    const float* p_sample = (const float*)d_in[5];
    W w;
    w.g_mix = (const float*)d_in[6]; w.w_in = (const float*)d_in[7]; w.conv_w = (const float*)d_in[8]; w.conv_b = (const float*)d_in[9];
    w.pool_w = (const float*)d_in[10]; w.pool_scale = (const float*)d_in[11]; w.w_out = (const float*)d_in[12]; w.g_ple = (const float*)d_in[13];
    w.w_gate = (const float*)d_in[14]; w.w_ple = (const float*)d_in[15]; w.g_final = (const float*)d_in[16];
    float* out = (float*)d_out;
    const size_t SEQ = 16384;
    float* y_prompt = out;
    float* y_sample = y_prompt + 2 * SEQ * D_MODEL;
    float* sc_prompt = y_sample + 32 * 32 * D_MODEL;
    float* sp_prompt = sc_prompt + 2 * 2 * W_A;
    float* sc_sample = sp_prompt + 2 * 15 * W_B;
    float* sp_sample = sc_sample + 32 * 2 * W_A;
    float* bufA = (float*)d_ws;
    float* bufP = bufA + SEQ * D_MODEL;
    float* bufY = bufP + SEQ * PROJ_W;
    for (int b = 0; b < 2; ++b)
        run_trunk(x_prompt + b * SEQ * D_MODEL, p_prompt + b * SEQ * PLE, nullptr, nullptr, 1, (int)SEQ, 0, w,
                  y_prompt + b * SEQ * D_MODEL, sc_prompt + b * 2 * W_A, sp_prompt + b * 15 * W_B, bufA, bufP, bufY, stream);
    run_trunk(x_sample, p_sample, cache_conv, cache_pool, 32, 32, 2048, w, y_sample, sc_sample, sp_sample, bufA, bufP, bufY, stream);
}
```
